# Optimizing an MI355X kernel written in HIP

```python
import math
import jax, jax.numpy as jnp
from jax import lax
import numpy as np

D_MODEL = 1024
BATCH = 2
SEQ = 16384
DEPTH = 2

N_A_LAYERS = DEPTH // 2
N_B_LAYERS = DEPTH - N_A_LAYERS
CONV_WIDTH = 3
N_HEADS = 8
HEAD_DIM = 64
ATT_WIDTH = N_HEADS * HEAD_DIM
Q_BLOCK = 128
RMS_EPS = 1e-6

kernel_name = "yoco_shortconv_stickbreaking"


def _rmsnorm(x, g):
    xf = x.astype(jnp.float32)
    y = xf * lax.rsqrt(jnp.mean(xf * xf, axis=-1, keepdims=True) + RMS_EPS)
    return (y * g.astype(jnp.float32)).astype(x.dtype)


def _causal_depthwise_conv(u, w):
    return lax.conv_general_dilated(
        u, w[:, None, :].astype(u.dtype),
        window_strides=(1,),
        padding=[(CONV_WIDTH - 1, 0)],
        dimension_numbers=("NWC", "WIO", "NWC"),
        feature_group_count=u.shape[-1])


def _short_conv_mixer(h, w_in, w_conv, w_out):
    u = h @ w_in
    b_gate, c_gate, xin, g = jnp.split(u, 4, axis=-1)
    y = b_gate * _causal_depthwise_conv(c_gate * xin, w_conv)
    return (y * jax.nn.silu(g)) @ w_out


def _stick_breaking_attention(q, k, v):
    seq = q.shape[2]
    n_blocks = seq // Q_BLOCK
    scale = HEAD_DIM ** -0.5
    qf = q.astype(jnp.float32)
    kf = k.astype(jnp.float32)
    vf = v.astype(jnp.float32)
    outs = []
    for blk in range(n_blocks):
        q0 = blk * Q_BLOCK
        kl = q0 + Q_BLOCK
        qb = qf[:, :, q0:kl]
        z = jnp.einsum("bhqd,bhkd->bhqk", qb, kf[:, :, :kl]) * scale
        q_pos = q0 + jnp.arange(Q_BLOCK)
        mask = jnp.arange(kl)[None, :] < q_pos[:, None]
        log_one_minus = jnp.where(mask, jax.nn.log_sigmoid(-z), 0.0)
        rev = lax.cumsum(log_one_minus, axis=3, reverse=True)
        weights = jnp.exp(jnp.where(mask, z + rev, -jnp.inf))
        outs.append(jnp.einsum("bhqk,bhkd->bhqd", weights, vf[:, :, :kl]))
    o = jnp.concatenate(outs, axis=2)
    return o.astype(q.dtype)


def setup_inputs(seed: int = 0) -> dict:
    key = jax.random.key(seed)
    ks = jax.random.split(key, 12)
    D = D_MODEL
    s = D ** -0.5
    f32 = jnp.float32
    return {
        "x": jax.random.normal(ks[0], (BATCH, SEQ, D), f32),
        "norm_a": 1.0 + 0.02 * jax.random.normal(ks[1], (N_A_LAYERS, D), f32),
        "w_in_a": s * jax.random.normal(ks[2], (N_A_LAYERS, D, 4 * D), f32),
        "conv_a": (CONV_WIDTH ** -0.5) * jax.random.normal(ks[3], (N_A_LAYERS, CONV_WIDTH, D), f32),
        "w_out_a": s * jax.random.normal(ks[4], (N_A_LAYERS, D, D), f32),
        "norm_kv": 1.0 + 0.02 * jax.random.normal(ks[5], (D,), f32),
        "w_kv": s * jax.random.normal(ks[6], (D, 2 * ATT_WIDTH), f32),
        "norm_b": 1.0 + 0.02 * jax.random.normal(ks[7], (N_B_LAYERS, D), f32),
        "w_in_b": s * jax.random.normal(ks[8], (N_B_LAYERS, D, 2 * ATT_WIDTH), f32),
        "w_out_b": (ATT_WIDTH ** -0.5) * jax.random.normal(ks[9], (N_B_LAYERS, ATT_WIDTH, D), f32),
        "norm_f": 1.0 + 0.02 * jax.random.normal(ks[10], (D,), f32),
    }


def reference(x, norm_a, w_in_a, conv_a, w_out_a, norm_kv, w_kv, norm_b, w_in_b, w_out_b, norm_f):
    bsz, seq, _ = x.shape
    k = v = None
    for layer in range(DEPTH):
        if layer < N_A_LAYERS:
            i = layer
            h = _rmsnorm(x, norm_a[i])
            x = x + _short_conv_mixer(h, w_in_a[i], conv_a[i], w_out_a[i])
            if layer == N_A_LAYERS - 1:
                kv = _rmsnorm(x, norm_kv) @ w_kv
                k, v = jnp.split(kv, 2, axis=-1)
                k = k.reshape(bsz, seq, N_HEADS, HEAD_DIM).transpose(0, 2, 1, 3)
                v = v.reshape(bsz, seq, N_HEADS, HEAD_DIM).transpose(0, 2, 1, 3)
        else:
            j = layer - N_A_LAYERS
            h = _rmsnorm(x, norm_b[j])
            q, g = jnp.split(h @ w_in_b[j], 2, axis=-1)
            q = q.reshape(bsz, seq, N_HEADS, HEAD_DIM).transpose(0, 2, 1, 3)
            o = _stick_breaking_attention(q, k, v)
            o = o.transpose(0, 2, 1, 3).reshape(bsz, seq, ATT_WIDTH)
            x = x + (o * jax.nn.silu(g)) @ w_out_b[j]
    return _rmsnorm(x, norm_f)
```

```cpp
#include <hip/hip_runtime.h>
#include <hip/hip_cooperative_groups.h>
#include <cstdio>
#include <cstdint>
namespace pg8 {
#define PG8_LAS __attribute__((address_space(3)))
typedef unsigned short bf16_t;
typedef short bf16x8 __attribute__((ext_vector_type(8)));
typedef float f32x4 __attribute__((ext_vector_type(4)));
typedef unsigned u32x4 __attribute__((ext_vector_type(4)));
constexpr int BM = 256, BK = 64, HALF = 128, HTB = HALF * BK * 2  , STAGE_BYTES = 8 * HTB, NXCD = 8, WGM = 8;

__host__ __device__ __forceinline__ int lds_byte(int r, int c) { const int st = (r >> 4) * 2 + (c >> 5), rr = r & 15, cc = c & 31, ob = rr * 64 + cc * 2; return st * 1024 + (ob ^ (((ob >> 9) & 1) << 5)); }
__host__ __device__ __forceinline__ void stage_rc(int b, int& R, int& C) { const int st = b / 1024, sb = b % 1024, swz = sb ^ (((sb >> 9) & 1) << 5); R = (st >> 1) * 16 + swz / 64; C = (st & 1) * 32 + (swz % 64) / 2; }
__host__ __device__ __forceinline__ int perm32(int rho) { const int n = rho >> 4, i = rho & 15; return 8 * (i >> 2) + 4 * n + (i & 3); }

struct Unit { int pm, pn; };
struct Gemm { const bf16_t* A; const bf16_t* Bt; int M, N, K; };

struct StaticOrder {
    int nM, nN, nwg, G, c;
    __host__ __device__ void init(int M, int N, int G_, int c_) { nM = M / BM; nN = N / BM; nwg = nM * nN; G = G_; c = c_; }
    __host__ __device__ bool next(int i, Unit& u) const {
        const long L = (long)i * G + c; if (L >= nwg) return false;
        int wgid = (int)L; { const int q = nwg / NXCD, r = nwg % NXCD, xcd = wgid % NXCD, off = wgid / NXCD; wgid = (xcd < r ? xcd * (q + 1) : r * (q + 1) + (xcd - r) * q) + off; }
        const int nig = WGM * nN, gid = wgid / nig, fm = gid * WGM, gsz = (nM - fm) < WGM ? (nM - fm) : WGM;
        u.pm = fm + ((wgid % nig) % gsz); u.pn = (wgid % nig) / gsz; return true;
    }
    __device__ __forceinline__ void a_ready(const Unit&) const {}
    __device__ __forceinline__ void done(const Unit&) const {}
};

__device__ __forceinline__ unsigned cvt_pk_bf16(float lo, float hi) { unsigned r; asm volatile("v_cvt_pk_bf16_f32 %0, %1, %2" : "=v"(r) : "v"(lo), "v"(hi)); return r; }
typedef float f32x2 __attribute__((ext_vector_type(2)));
typedef unsigned u32x2 __attribute__((ext_vector_type(2)));
__device__ __forceinline__ float silu_f(float g) { return g * __builtin_amdgcn_rcpf(1.f + __builtin_amdgcn_exp2f(-1.4426950408889634f * g)); }

struct EpiMix1 {
    static constexpr bool PERM = false, AFTER_DRAIN = false;
    const float* rstd; bf16_t* P; bf16_t* BG;
    __device__ __forceinline__ void operator()(const f32x4 (&acc)[2][2][4][2], const Unit& u, int wr, int wc, int fr, int fq) const {
        const int ch = u.pn * 64 + wc * 16 + fq * 4;
#pragma unroll
        for (int ai = 0; ai < 2; ++ai)
#pragma unroll
            for (int m = 0; m < 4; ++m) {
                const int row = u.pm * BM + ai * HALF + wr * 64 + m * 16 + fr;
                const float rs = rstd[row];
                const f32x4 B = acc[ai][0][m][0] * rs, C = acc[ai][0][m][1] * rs, X = acc[ai][1][m][0] * rs, G = acc[ai][1][m][1] * rs;
                const f32x4 p = C * X;
                f32x4 bg;
#pragma unroll
                for (int e = 0; e < 4; ++e) bg[e] = B[e] * silu_f(G[e]);
                u32x2 wp, wb; wp.x = cvt_pk_bf16(p[0], p[1]); wp.y = cvt_pk_bf16(p[2], p[3]); wb.x = cvt_pk_bf16(bg[0], bg[1]); wb.y = cvt_pk_bf16(bg[2], bg[3]);
                *(u32x2*)(P + (size_t)row * 1024 + ch) = wp;
                *(u32x2*)(BG + (size_t)row * 1024 + ch) = wb;
            }
    }
};

template <bool WRITE_BF16> struct EpiRes {
    static constexpr bool PERM = false, AFTER_DRAIN = false;
    const float* base; float* out; bf16_t* outb; float* ssq;
    __device__ __forceinline__ void operator()(const f32x4 (&acc)[2][2][4][2], const Unit& u, int wr, int wc, int fr, int fq) const {
        const int col0 = u.pn * BM + wc * 32 + 4 * fq;
#pragma unroll
        for (int ai = 0; ai < 2; ++ai)
#pragma unroll
            for (int m = 0; m < 4; ++m) {
                const int row = u.pm * BM + ai * HALF + wr * 64 + m * 16 + fr;
                const size_t off = (size_t)row * 1024 + col0;
                float s = 0.f;
#pragma unroll
                for (int bj = 0; bj < 2; ++bj)
#pragma unroll
                    for (int n = 0; n < 2; ++n) {
                        const f32x4 bs = *(const f32x4*)(base + off + bj * HALF + n * 16);
                        const f32x4 v = bs + acc[ai][bj][m][n];
                        s += (v[0] * v[0] + v[1] * v[1]) + (v[2] * v[2] + v[3] * v[3]);
                        *(f32x4*)(out + off + bj * HALF + n * 16) = v;
                        if (WRITE_BF16) { u32x2 w; w.x = cvt_pk_bf16(v[0], v[1]); w.y = cvt_pk_bf16(v[2], v[3]); *(u32x2*)(outb + off + bj * HALF + n * 16) = w; }
                    }
                s += __shfl_xor(s, 16); s += __shfl_xor(s, 32);
                if (fq == 0) unsafeAtomicAdd(ssq + row, s);
            }
    }
};

struct EpiKVQG {
    static constexpr bool PERM = true, AFTER_DRAIN = false;
    const float* ssq; bf16_t* O; size_t tstride; float eps;
    __device__ __forceinline__ void operator()(const f32x4 (&acc)[2][2][4][2], const Unit& u, int wr, int wc, int fr, int fq) const {
        const int t = u.pn >> 1;
        bf16_t* base = O + (size_t)t * tstride;
        const int col0 = (u.pn & 1) * 256 + wc * 32 + 8 * fq;
        const float tsc = (t == 2) ? (0.125f * 1.4426950408889634f) : 1.f;
#pragma unroll
        for (int ai = 0; ai < 2; ++ai)
#pragma unroll
            for (int m = 0; m < 4; ++m) {
                const int row = u.pm * BM + ai * HALF + wr * 64 + m * 16 + fr;
                const float sc = __builtin_amdgcn_rsqf(ssq[row] * (1.f / 1024.f) + eps) * tsc;
                bf16_t* rowp = base + (size_t)row * 512 + col0;
#pragma unroll
                for (int bj = 0; bj < 2; ++bj) {
                    f32x4 v0 = acc[ai][bj][m][0] * sc, v1 = acc[ai][bj][m][1] * sc;
                    if (t == 3) {
#pragma unroll
                        for (int e = 0; e < 4; ++e) { v0[e] = silu_f(v0[e]); v1[e] = silu_f(v1[e]); }
                    }
                    u32x4 w; w.x = cvt_pk_bf16(v0[0], v0[1]); w.y = cvt_pk_bf16(v0[2], v0[3]); w.z = cvt_pk_bf16(v1[0], v1[1]); w.w = cvt_pk_bf16(v1[2], v1[3]);
                    *(u32x4*)(rowp + bj * HALF) = w;
                }
            }
    }
};
template <class Epi, class Sched, bool ALIGN_EPI = false, bool SP2 = false>
__device__ __forceinline__ void gemm_phase(PG8_LAS unsigned char* lds, const Gemm g, const Sched& S, const Epi& E) {
    const int tid = threadIdx.x, wid = __builtin_amdgcn_readfirstlane(tid >> 6), lane = tid & 63, wr = wid >> 2, wc = wid & 3, fr = lane & 15, fq = lane >> 4;
    const int K = g.K, nt = K / BK;
    unsigned voffA[2], voffB[2];
#pragma unroll
    for (int i = 0; i < 2; ++i) { int R, C; stage_rc(tid * 16 + i * 8192, R, C); const int Rb = Epi::PERM ? ((R & ~31) + perm32(R & 31)) : R;
        voffA[i] = (unsigned)(R * K + C) * 2u; voffB[i] = (unsigned)(Rb * K + C) * 2u; }
    const size_t kstep = (size_t)(BK * 2);
    const size_t hstep = (size_t)HALF * K * 2;
    const size_t tstep = 2 * hstep;
    const unsigned ldsw = (unsigned)wid * 1024u;
    const int aoff = lds_byte(wr * 64 + fr, fq * 8), boff = lds_byte(wc * 32 + fr, fq * 8);
#define PG8_SA(b, h) (((b) * 2 + (h)) * HTB)
#define PG8_SB(b, h) ((4 + (b) * 2 + (h)) * HTB)
#define PG8_STAGE(bufoff, gbase, voff) do { _Pragma("unroll") for (int _i = 0; _i < 2; ++_i) \
        __builtin_amdgcn_global_load_lds((const unsigned*)((const char*)(gbase) + (voff)[_i]), (PG8_LAS unsigned*)(lds + (bufoff) + ldsw + _i * 8192), 16, 0, 0); } while (0)
#define PG8_LDA(dst, b, h) do { _Pragma("unroll") for (int m = 0; m < 4; ++m) _Pragma("unroll") for (int k = 0; k < 2; ++k) dst[m][k] = *(const PG8_LAS bf16x8*)(lds + PG8_SA(b, h) + aoff + m * 2048 + k * 1024); } while (0)
#define PG8_LDB(dst, b, h) do { _Pragma("unroll") for (int n = 0; n < 2; ++n) _Pragma("unroll") for (int k = 0; k < 2; ++k) dst[n][k] = *(const PG8_LAS bf16x8*)(lds + PG8_SB(b, h) + boff + n * 2048 + k * 1024); } while (0)
#define PG8_MMA(ai, bj, At, Bt) do { __builtin_amdgcn_s_setprio(1); _Pragma("unroll") for (int m = 0; m < 4; ++m) _Pragma("unroll") for (int n = 0; n < 2; ++n) _Pragma("unroll") for (int k = 0; k < 2; ++k) \
        acc[ai][bj][m][n] = __builtin_amdgcn_mfma_f32_16x16x32_bf16(Bt[n][k], At[m][k], acc[ai][bj][m][n], 0, 0, 0); __builtin_amdgcn_s_setprio(0); } while (0)
#define PG8_WAIT_V(n) asm volatile("s_waitcnt vmcnt(" #n ")" ::: "memory")
#define PG8_WAIT_L(n) asm volatile("s_waitcnt lgkmcnt(" #n ")" ::: "memory")
#define PG8_BAR __builtin_amdgcn_s_barrier()
#define PG8_SCHED __builtin_amdgcn_sched_barrier(0)
    Unit cur, nxt; int ui = 0;
    if (!S.next(0, cur)) return;
    f32x4 acc[2][2][4][2];
#pragma unroll
    for (int a = 0; a < 2; ++a)
#pragma unroll
        for (int b = 0; b < 2; ++b)
#pragma unroll
            for (int m = 0; m < 4; ++m)
#pragma unroll
                for (int n = 0; n < 2; ++n) acc[a][b][m][n] = (f32x4){0.f, 0.f, 0.f, 0.f};
    bf16x8 At[4][2], B0[2][2], B1[2][2];
    const char* cA = (const char*)g.A + (size_t)cur.pm * tstep; const char* cB = (const char*)g.Bt + (size_t)cur.pn * tstep;
    S.a_ready(cur);
    if constexpr (SP2) {
        PG8_STAGE(PG8_SB(0, 0), cB, voffB); PG8_STAGE(PG8_SB(0, 1), cB + hstep, voffB); PG8_STAGE(PG8_SA(0, 0), cA, voffA); PG8_STAGE(PG8_SA(0, 1), cA + hstep, voffA);
        if (wr == 1) PG8_BAR;
        PG8_WAIT_V(2); PG8_BAR;
        PG8_STAGE(PG8_SB(1, 0), cB + kstep, voffB); PG8_STAGE(PG8_SA(1, 0), cA + kstep, voffA); PG8_STAGE(PG8_SB(1, 1), cB + hstep + kstep, voffB);
        PG8_WAIT_V(6); PG8_BAR;
    } else {
        PG8_STAGE(PG8_SB(0, 0), cB, voffB); PG8_STAGE(PG8_SA(0, 0), cA, voffA); PG8_STAGE(PG8_SB(0, 1), cB + hstep, voffB); PG8_STAGE(PG8_SA(0, 1), cA + hstep, voffA);
        if (wr == 1) PG8_BAR;
        PG8_WAIT_V(4); PG8_BAR;
        PG8_STAGE(PG8_SB(1, 0), cB + kstep, voffB); PG8_STAGE(PG8_SA(1, 0), cA + kstep, voffA); PG8_STAGE(PG8_SB(1, 1), cB + hstep + kstep, voffB);
        PG8_WAIT_V(6); PG8_BAR;
    }
    for (;;) {
        const bool has_next = S.next(ui + 1, nxt);
        const char* nA = has_next ? (const char*)g.A + (size_t)nxt.pm * tstep : cA; const char* nB = has_next ? (const char*)g.Bt + (size_t)nxt.pn * tstep : cB;
        for (int t = 0; t < nt; t += 2) {
            const bool last = (t == nt - 2);
            const char* a1 = cA + (size_t)(t + 1) * kstep;
            const char* a2 = last ? nA : cA + (size_t)(t + 2) * kstep; const char* b2 = last ? nB : cB + (size_t)(t + 2) * kstep;
            const char* a3 = a2 + kstep; const char* b3 = b2 + kstep;
            if (last && has_next) S.a_ready(nxt);
            if constexpr (SP2) {
            PG8_LDB(B0, 0, 0); PG8_LDB(B1, 0, 1); PG8_SCHED; PG8_LDA(At, 0, 0); PG8_STAGE(PG8_SA(1, 1), a1 + hstep, voffA);
            PG8_WAIT_V(8); PG8_WAIT_L(0); PG8_BAR; PG8_MMA(0, 0, At, B0); PG8_MMA(0, 1, At, B1); PG8_BAR; PG8_SCHED;
            PG8_LDA(At, 0, 1); PG8_STAGE(PG8_SB(0, 0), b2, voffB); PG8_STAGE(PG8_SB(0, 1), b2 + hstep, voffB); PG8_STAGE(PG8_SA(0, 0), a2, voffA);
            PG8_WAIT_V(8); PG8_WAIT_L(0); PG8_BAR; PG8_MMA(1, 0, At, B0); PG8_MMA(1, 1, At, B1); PG8_BAR; PG8_SCHED;
            PG8_LDB(B0, 1, 0); PG8_LDB(B1, 1, 1); PG8_SCHED; PG8_LDA(At, 1, 0); PG8_STAGE(PG8_SA(0, 1), a2 + hstep, voffA);
            PG8_WAIT_V(8); PG8_WAIT_L(0); PG8_BAR; PG8_MMA(0, 0, At, B0); PG8_MMA(0, 1, At, B1); PG8_BAR; PG8_SCHED;
            PG8_LDA(At, 1, 1); PG8_STAGE(PG8_SB(1, 0), b3, voffB); PG8_STAGE(PG8_SB(1, 1), b3 + hstep, voffB); PG8_STAGE(PG8_SA(1, 0), a3, voffA);
            PG8_WAIT_V(8); PG8_WAIT_L(0); PG8_BAR; PG8_MMA(1, 0, At, B0); PG8_MMA(1, 1, At, B1); PG8_BAR; PG8_SCHED;
            } else {
            PG8_LDB(B0, 0, 0); PG8_SCHED; PG8_LDA(At, 0, 0); PG8_STAGE(PG8_SA(1, 1), a1 + hstep, voffA);
            PG8_WAIT_L(8); PG8_BAR; PG8_WAIT_L(0); PG8_MMA(0, 0, At, B0); PG8_BAR; PG8_SCHED;
            PG8_LDB(B1, 0, 1); PG8_STAGE(PG8_SB(0, 0), b2, voffB);
            PG8_BAR; PG8_WAIT_L(0); PG8_MMA(0, 1, At, B1); PG8_BAR;
            PG8_LDA(At, 0, 1); PG8_STAGE(PG8_SA(0, 0), a2, voffA);
            PG8_BAR; PG8_WAIT_L(0); PG8_MMA(1, 0, At, B0); PG8_BAR; PG8_SCHED;
            PG8_STAGE(PG8_SB(0, 1), b2 + hstep, voffB);
            PG8_WAIT_V(6); PG8_BAR; PG8_MMA(1, 1, At, B1); PG8_BAR;
            PG8_LDB(B0, 1, 0); PG8_SCHED; PG8_LDA(At, 1, 0); PG8_STAGE(PG8_SA(0, 1), a2 + hstep, voffA);
            PG8_WAIT_L(8); PG8_BAR; PG8_WAIT_L(0); PG8_MMA(0, 0, At, B0); PG8_BAR; PG8_SCHED;
            PG8_LDB(B1, 1, 1); PG8_STAGE(PG8_SB(1, 0), b3, voffB);
            PG8_BAR; PG8_WAIT_L(0); PG8_MMA(0, 1, At, B1); PG8_BAR;
            PG8_LDA(At, 1, 1); PG8_STAGE(PG8_SA(1, 0), a3, voffA);
            PG8_BAR; PG8_WAIT_L(0); PG8_MMA(1, 0, At, B0); PG8_BAR; PG8_SCHED;
            PG8_STAGE(PG8_SB(1, 1), b3 + hstep, voffB);
            PG8_WAIT_V(6); PG8_BAR; PG8_MMA(1, 1, At, B1); PG8_BAR;
            }
        }
        if constexpr (ALIGN_EPI) { if (wr == 0) PG8_BAR; }
        if constexpr (!Epi::AFTER_DRAIN) { E(acc, cur, wr, wc, fr, fq); S.done(cur); }
        if (!has_next) break;
#pragma unroll
        for (int a = 0; a < 2; ++a)
#pragma unroll
            for (int b = 0; b < 2; ++b)
#pragma unroll
                for (int m = 0; m < 4; ++m)
#pragma unroll
                    for (int n = 0; n < 2; ++n) acc[a][b][m][n] = (f32x4){0.f, 0.f, 0.f, 0.f};
        cur = nxt; cA = nA; cB = nB; ++ui;
        if constexpr (ALIGN_EPI) { if (wr == 1) PG8_BAR; }
    }
    PG8_WAIT_V(0);
    if constexpr (!ALIGN_EPI) { if (wr == 0) PG8_BAR; }
    PG8_BAR;
    if constexpr (Epi::AFTER_DRAIN) { E.fused(acc, cur, wr, wc, fr, fq, lds, wid, lane); S.done(cur); }
#undef PG8_SA
#undef PG8_SB
#undef PG8_STAGE
#undef PG8_LDA
#undef PG8_LDB
#undef PG8_MMA
#undef PG8_WAIT_V
#undef PG8_WAIT_L
#undef PG8_BAR
#undef PG8_SCHED
}
}
#define GAS __attribute__((address_space(1)))
#define LAS __attribute__((address_space(3)))
typedef unsigned short bf16;
typedef unsigned v4u __attribute__((ext_vector_type(4)));
typedef float f32x4 __attribute__((ext_vector_type(4)));
typedef short bf16x8 __attribute__((ext_vector_type(8)));
typedef GAS unsigned gu32;
typedef GAS unsigned long long gu64;
#define RLX_AGENT __ATOMIC_RELAXED, __HIP_MEMORY_SCOPE_AGENT
#define LDS_WAIT() asm volatile("s_waitcnt lgkmcnt(0)" ::: "memory")
#define VM_WAIT() asm volatile("s_waitcnt vmcnt(0)" ::: "memory")
__device__ __forceinline__ unsigned long long rt() { return __builtin_amdgcn_s_memrealtime(); }
__device__ __forceinline__ unsigned f2bf(float f) { unsigned u = __builtin_bit_cast(unsigned, f); return (u + 0x7fffu + ((u >> 16) & 1u)) >> 16; }
__device__ __forceinline__ unsigned pk2(float lo, float hi) { return f2bf(lo) | (f2bf(hi) << 16); }

#define XB_TMO      128
#define XB_XCNT(j)  (256  + 64 * (j))
#define XB_XSUB(j)  (1280 + 64 * (j))
#define XB_XGEN(j)  (2304 + 64 * (j))
#define XB_TOP      3328
#define XB_TOPGEN   3392
#define XCD_BAR_WORDS 3456
#define XB_SPIN_CAP (1u << 18)

__device__ __forceinline__ unsigned xb_ld(unsigned* p)              { return __hip_atomic_load(p, __ATOMIC_RELAXED, __HIP_MEMORY_SCOPE_AGENT); }
__device__ __forceinline__ unsigned xb_add(unsigned* p, unsigned v) { return __hip_atomic_fetch_add(p, v, __ATOMIC_RELAXED, __HIP_MEMORY_SCOPE_AGENT); }
__device__ __forceinline__ unsigned xb_xcc_id() { return (unsigned)__builtin_amdgcn_s_getreg((3 << 11) | 20) & 0xFu; }
#define XB_SPIN(cond, bar) do { unsigned _sp = 0; while (cond) { __builtin_amdgcn_s_sleep(1); \
    if ((++_sp & 255u) == 0u) { if (xb_ld(&(bar)[XB_TMO])) break; if (_sp > XB_SPIN_CAP) { atomicAdd(&(bar)[XB_TMO], 1u); break; } } } } while (0)

struct XcdBarrier {
    unsigned* bar; unsigned x;
    volatile LAS unsigned* st;
};

__device__ __forceinline__ XcdBarrier xcd_barrier_post(unsigned* bar, volatile LAS unsigned* st) {
    XcdBarrier b; b.bar = bar; b.x = xb_xcc_id(); b.st = st;
    if (threadIdx.x == 0) (void)xb_add(&bar[XB_XCNT(b.x)], 1u);
    return b;
}
__device__ __forceinline__ void xcd_barrier_complete(unsigned* bar, unsigned x, unsigned& nloc, unsigned& nx) {
    const unsigned G = gridDim.x * gridDim.y * gridDim.z;
    unsigned sum, cnt, mine, sp = 0u;
    for (;;) {
        sum = 0u; cnt = 0u; mine = 0u;
#pragma unroll
        for (unsigned j = 0; j < 16; ++j) { const unsigned c = xb_ld(&bar[XB_XCNT(j)]); sum += c; cnt += (c > 0u) ? 1u : 0u; mine = (j == x) ? c : mine; }
        if (sum == G) break;
        __builtin_amdgcn_s_sleep(1);
        if ((++sp & 255u) == 0u) { if (xb_ld(&bar[XB_TMO])) break; if (sp > XB_SPIN_CAP) { atomicAdd(&bar[XB_TMO], 1u); break; } }
    }
    nloc = mine > 0u ? mine : 1u; nx = cnt > 0u ? cnt : 1u;
}

__device__ __forceinline__ void xcd_barrier(const XcdBarrier& b) {
    asm volatile("s_waitcnt vmcnt(0)" ::: "memory");
    __syncthreads();
    if (threadIdx.x == 0) {
        unsigned* bar = b.bar;
        __builtin_amdgcn_s_waitcnt(0);
        unsigned nloc = b.st[0], nx = b.st[1];
        if (nloc == 0u) { xcd_barrier_complete(bar, b.x, nloc, nx); b.st[0] = nloc; b.st[1] = nx; }
        const unsigned old = xb_add(&bar[XB_XSUB(b.x)], 1u);
        const unsigned gen = old / nloc;
        if (old + 1u == (gen + 1u) * nloc) {
            __builtin_amdgcn_fence(__ATOMIC_RELEASE, "agent");
            asm volatile("s_waitcnt vmcnt(0)" ::: "memory");
            const unsigned og = xb_add(&bar[XB_TOP], 1u);
            const unsigned tg = og / nx;
            if (og + 1u == (tg + 1u) * nx) xb_add(&bar[XB_TOPGEN], 1u);
            else XB_SPIN(xb_ld(&bar[XB_TOPGEN]) == tg, bar);
            __builtin_amdgcn_fence(__ATOMIC_ACQUIRE, "agent");
            xb_add(&bar[XB_XGEN(b.x)], 1u);
            asm volatile("s_waitcnt vmcnt(0)" ::: "memory");
        } else {
            XB_SPIN(xb_ld(&bar[XB_XGEN(b.x)]) == gen, bar);
            __builtin_amdgcn_fence(__ATOMIC_ACQUIRE, "agent");
            asm volatile("s_waitcnt vmcnt(0)" ::: "memory");
        }
    }
    __syncthreads();
}

constexpr int NWAVES = 8;
constexpr int BATCH = 2, SEQ = 16384, D = 1024, NH = 8, HD = 64, AW = NH * HD  ;
constexpr int M = BATCH * SEQ;
constexpr float RMS_EPS = 1e-6f;

constexpr size_t MiB = 1u << 20;
constexpr size_t WS_CTL = 0, CTL_ZERO_BYTES = 64 * 1024;
constexpr size_t WS_RSTD0 = 1 * MiB, WS_SSQ1 = WS_RSTD0 + 128 * 1024, WS_SSQ2 = WS_SSQ1 + 128 * 1024;
constexpr size_t WS_W1 = 2 * MiB;
constexpr size_t WS_W2 = 10 * MiB;
constexpr size_t WS_W3 = 12 * MiB;
constexpr size_t WS_W4 = 16 * MiB;
constexpr size_t WS_XB = 32 * MiB;
constexpr size_t WS_K = WS_XB, WS_V = WS_XB + 32 * MiB;
constexpr size_t WS_P = 96 * MiB;
constexpr size_t WS_Q = WS_P, WS_G = WS_P + 32 * MiB;
constexpr size_t WS_BG = 160 * MiB;
constexpr size_t WS_OG = WS_BG;
constexpr size_t WS_Y = 224 * MiB;
constexpr size_t WS_X1 = 288 * MiB;
constexpr size_t WS_X1B = 416 * MiB;
constexpr size_t WS_END = 480 * MiB;
constexpr int CW_BAR = 1024;

constexpr int RING_OFF = 0, RING_BYTES = 131072;
constexpr int LDSCTL_OFF = RING_BYTES, MISC_OFF = LDSCTL_OFF + 320;
constexpr int LDS_BYTES = 147456;

struct Frame {
    LAS unsigned char* lds;
    int tid, lane, wave;
    int vcu, G;
};

__device__ __forceinline__ float wave_sum(float v) {
#pragma unroll
    for (int o = 1; o < 64; o <<= 1) v += __shfl_xor(v, o);
    return v;
}

__device__ __forceinline__ void p0_transpose_item(const float* W, int K, int N, const float* gain, bf16* WT, int mode, LAS float* scr, int item, int lane) {
    const int nblk = N / 32, kb = item / nblk, nb = item % nblk, k0 = 64 * kb, n0 = 32 * nb;
    const int j = lane & 31;
    int col = n0 + j;
    if (mode == 1) { const int pn = n0 >> 8, c0 = n0 & 255, bj = c0 >> 7, wc = (c0 >> 5) & 3; col = (2 * bj + (j >> 4)) * 1024 + 64 * pn + 16 * wc + (j & 15); }
#pragma unroll 8
    for (int i = 0; i < 32; ++i) { const int kk = 2 * i + (lane >> 5); const float g = gain ? gain[k0 + kk] : 1.f; scr[kk * 33 + j] = W[(size_t)(k0 + kk) * N + col] * g; }
    LDS_WAIT(); asm volatile("" ::: "memory");
    const int c = lane & 7;
#pragma unroll
    for (int jj = 0; jj < 4; ++jj) { const int n = (lane >> 3) + 8 * jj; const LAS float* s = scr + (8 * c) * 33 + n;
        v4u o; o.x = pk2(s[0 * 33], s[1 * 33]); o.y = pk2(s[2 * 33], s[3 * 33]); o.z = pk2(s[4 * 33], s[5 * 33]); o.w = pk2(s[6 * 33], s[7 * 33]);
        *(GAS v4u*)(WT + (size_t)(n0 + n) * K + k0 + 8 * c) = o; }
    LDS_WAIT(); asm volatile("" ::: "memory");
}

struct Ptrs {
    const float *x, *norm_a, *w_in_a, *conv_a, *w_out_a, *norm_kv, *w_kv, *norm_b, *w_in_b, *w_out_b, *norm_f;
    float* out; unsigned char* ws;
};

__device__ __forceinline__ void p0_prologue(Frame& F, const Ptrs& A) {
    LAS float* scr = (LAS float*)(F.lds + RING_OFF + F.wave * 16384);
    const int gw = F.vcu * NWAVES + F.wave, NGW = F.G * NWAVES;
    bf16* W1 = (bf16*)(A.ws + WS_W1); bf16* W2 = (bf16*)(A.ws + WS_W2); bf16* W3 = (bf16*)(A.ws + WS_W3); bf16* W4 = (bf16*)(A.ws + WS_W4);
    constexpr int I_1 = (D / 64) * (4 * D / 32), I_2 = (D / 64) * (D / 32), I_4 = (AW / 64) * (D / 32);
    constexpr int NITEMS = I_1 + 3 * I_2 + I_4;
    for (int it = gw; it < NITEMS; it += NGW) {
        int r = it;
        if (r < I_1) { p0_transpose_item(A.w_in_a, D, 4 * D, A.norm_a, W1, 1, scr, r, F.lane); continue; } r -= I_1;
        if (r < I_2) { p0_transpose_item(A.w_out_a, D, D, nullptr, W2, 0, scr, r, F.lane); continue; } r -= I_2;
        if (r < I_2) { p0_transpose_item(A.w_kv, D, D, A.norm_kv, W3, 0, scr, r, F.lane); continue; } r -= I_2;
        if (r < I_2) { p0_transpose_item(A.w_in_b, D, D, A.norm_b, W3 + (size_t)D * D, 0, scr, r, F.lane); continue; } r -= I_2;
        p0_transpose_item(A.w_out_b, AW, D, nullptr, W4, 0, scr, r, F.lane);
    }
    bf16* XB = (bf16*)(A.ws + WS_XB); float* rstd0 = (float*)(A.ws + WS_RSTD0); float* ssq1 = (float*)(A.ws + WS_SSQ1); float* ssq2 = (float*)(A.ws + WS_SSQ2);
    for (int m = gw; m < M; m += NGW) {
        const GAS f32x4* xr = (const GAS f32x4*)(A.x + (size_t)m * D) + F.lane;
        f32x4 v[4]; float s = 0.f;
#pragma unroll
        for (int j = 0; j < 4; ++j) { v[j] = xr[64 * j]; s += (v[j].x * v[j].x + v[j].y * v[j].y) + (v[j].z * v[j].z + v[j].w * v[j].w); }
        const float rstd = __builtin_amdgcn_rsqf(wave_sum(s) * (1.f / D) + RMS_EPS);
        GAS unsigned long long* o8 = (GAS unsigned long long*)(XB + (size_t)m * D) + F.lane;
#pragma unroll
        for (int j = 0; j < 4; ++j) o8[64 * j] = (unsigned long long)pk2(v[j].x, v[j].y) | ((unsigned long long)pk2(v[j].z, v[j].w) << 32);
        if (F.lane == 0) { rstd0[m] = rstd; ssq1[m] = 0.f; ssq2[m] = 0.f; }
    }
}

__device__ __forceinline__ void unpack8(const v4u& u, float* f) {
#pragma unroll
    for (int i = 0; i < 4; ++i) { f[2 * i] = __uint_as_float(u[i] << 16); f[2 * i + 1] = __uint_as_float(u[i] & 0xffff0000u); }
}
__device__ __forceinline__ void conv_pass(Frame& F, const Ptrs& A) {
    const bf16* P = (const bf16*)(A.ws + WS_P); const bf16* BG = (const bf16*)(A.ws + WS_BG); bf16* Y = (bf16*)(A.ws + WS_Y);
    const int gt = F.vcu * (NWAVES * 64) + F.tid, NGT = F.G * NWAVES * 64;
    constexpr int NIT = (M / 16) * (D / 8);
    for (int it = gt; it < NIT; it += NGT) {
        const int cg = it % (D / 8), t0 = (it / (D / 8)) * 16, c0 = cg * 8;
        float w0[8], w1[8], w2[8];
#pragma unroll
        for (int i = 0; i < 8; ++i) { w0[i] = A.conv_a[c0 + i]; w1[i] = A.conv_a[D + c0 + i]; w2[i] = A.conv_a[2 * D + c0 + i]; }
        float pm2[8], pm1[8];
        if ((t0 % SEQ) == 0) {
#pragma unroll
            for (int i = 0; i < 8; ++i) { pm2[i] = 0.f; pm1[i] = 0.f; }
        } else {
            const v4u a = *(const GAS v4u*)(P + (size_t)(t0 - 2) * D + c0), b = *(const GAS v4u*)(P + (size_t)(t0 - 1) * D + c0);
            unpack8(a, pm2); unpack8(b, pm1);
        }
#pragma unroll 4
        for (int r = 0; r < 16; ++r) {
            const size_t off = (size_t)(t0 + r) * D + c0;
            const v4u pu = *(const GAS v4u*)(P + off), bu = *(const GAS v4u*)(BG + off);
            float p0[8], bg[8], y[8];
            unpack8(pu, p0); unpack8(bu, bg);
#pragma unroll
            for (int i = 0; i < 8; ++i) { y[i] = bg[i] * (w0[i] * pm2[i] + w1[i] * pm1[i] + w2[i] * p0[i]); pm2[i] = pm1[i]; pm1[i] = p0[i]; }
            v4u o; o.x = pk2(y[0], y[1]); o.y = pk2(y[2], y[3]); o.z = pk2(y[4], y[5]); o.w = pk2(y[6], y[7]);
            *(GAS v4u*)(Y + off) = o;
        }
    }
}

__device__ __forceinline__ void final_norm(Frame& F, const Ptrs& A) {
    const int gw = F.vcu * NWAVES + F.wave, NGW = F.G * NWAVES;
    const float* ssq2 = (const float*)(A.ws + WS_SSQ2);
    f32x4 g[4];
#pragma unroll
    for (int j = 0; j < 4; ++j) g[j] = ((const GAS f32x4*)A.norm_f)[F.lane + 64 * j];
    for (int m = gw; m < M; m += NGW) {
        const float rs = __builtin_amdgcn_rsqf(ssq2[m] * (1.f / D) + RMS_EPS);
        GAS f32x4* xr = (GAS f32x4*)(A.out + (size_t)m * D) + F.lane;
#pragma unroll
        for (int j = 0; j < 4; ++j) { f32x4 v = xr[64 * j]; v = v * rs * g[j]; xr[64 * j] = v; }
    }
}

namespace sb {
typedef float f32x16 __attribute__((ext_vector_type(16)));
typedef short s16x4 __attribute__((ext_vector_type(4)));
constexpr float THRESH_LOG2 = -151.0f;
__device__ __forceinline__ unsigned cvtpk(float lo, float hi) { unsigned r; asm volatile("v_cvt_pk_bf16_f32 %0, %1, %2" : "=v"(r) : "v"(lo), "v"(hi)); return r; }
__device__ __forceinline__ s16x4 vtr(const LAS unsigned char* p) { return __builtin_bit_cast(s16x4, __builtin_amdgcn_ds_read_tr16_b64_v4i16((LAS s16x4*)p)); }

template <bool MASK>
__device__ __forceinline__ void tile_math(f32x16& p0, f32x16& p1, float& carry, int klim  , int hi) {
    float gs[2][4];
#pragma unroll
    for (int blk = 0; blk < 2; ++blk) {
        f32x16& p = blk ? p1 : p0;
#pragma unroll
        for (int g = 0; g < 4; ++g) {
            float run = 0.f;
#pragma unroll
            for (int e = 3; e >= 0; --e) {
                const int r = 4 * g + e;
                const float z = p[r];
                const float t = __builtin_amdgcn_exp2f(-__builtin_fabsf(z));
                float lom = __builtin_fminf(-z, 0.f) - __builtin_amdgcn_logf(1.f + t);
                if (MASK) { const bool valid = (32 * blk + 8 * g + e) < klim; lom = valid ? lom : 0.f; }
                run += lom;
                p[r] = z + run;
            }
            gs[blk][g] = run;
        }
    }
    float Gs[16];
#pragma unroll
    for (int blk = 0; blk < 2; ++blk)
#pragma unroll
        for (int g = 0; g < 4; ++g) {
            auto rr = __builtin_amdgcn_permlane32_swap(__float_as_uint(gs[blk][g]), __float_as_uint(gs[blk][g]), false, false);
            Gs[8 * blk + 2 * g] = __uint_as_float(rr[0]); Gs[8 * blk + 2 * g + 1] = __uint_as_float(rr[1]);
        }
    float base[16];
    base[15] = carry;
#pragma unroll
    for (int G = 14; G >= 0; --G) base[G] = base[G + 1] + Gs[G + 1];
    carry = base[0] + Gs[0];
#pragma unroll
    for (int blk = 0; blk < 2; ++blk) {
        f32x16& p = blk ? p1 : p0;
#pragma unroll
        for (int g = 0; g < 4; ++g) {
            const float mb = hi ? base[8 * blk + 2 * g + 1] : base[8 * blk + 2 * g];
#pragma unroll
            for (int e = 0; e < 4; ++e) {
                const int r = 4 * g + e;
                float w = __builtin_amdgcn_exp2f(p[r] + mb);
                if (MASK) { const bool valid = (32 * blk + 8 * g + e) < klim; w = valid ? w : 0.f; }
                p[r] = w;
            }
        }
    }
}

__device__ __forceinline__ void attn_unit(int b, int h, int qblk, const bf16* Q, const bf16* K, const bf16* V, const bf16* Gt, bf16* O, LAS unsigned char* vlds, int lane) {
    const int r32 = lane & 31, hi = lane >> 5;
    const int q0 = qblk * 32;
    const size_t rowbase = (size_t)b * SEQ;
    bf16x8 qf[4];
    { const bf16* qp = Q + (rowbase + q0 + r32) * AW + h * HD + hi * 8;
#pragma unroll
      for (int d0 = 0; d0 < 4; ++d0) qf[d0] = *(const GAS bf16x8*)(qp + d0 * 16); }
    f32x16 o0 = {}, o1 = {};
    float carry = 0.f;
    int kb = q0 >= 32 ? q0 - 32 : 0, lim = 0x7fffffff;
    const int qpos = q0 + r32;
    const LAS unsigned char* vrd = vlds + ((lane >> 4) & 1) * 32 + (lane & 3) * 8 + (4 * hi + ((lane & 15) >> 2)) * 64;
    for (;;) {
        const bf16* kp = K + (rowbase + kb + r32) * AW + h * HD + hi * 8;
        bf16x8 kf[2][4];
#pragma unroll
        for (int blk = 0; blk < 2; ++blk)
#pragma unroll
            for (int d0 = 0; d0 < 4; ++d0) kf[blk][d0] = *(const GAS bf16x8*)(kp + (size_t)blk * 32 * AW + d0 * 16);
        const bf16* vp = V + (rowbase + kb + (lane >> 2)) * AW + h * HD + (lane & 3) * 8;
        v4u vv[8];
#pragma unroll
        for (int i = 0; i < 8; ++i) vv[i] = *(const GAS v4u*)(vp + (size_t)(i & 3) * 16 * AW + (i >> 2) * 32);
        f32x16 p0 = {}, p1 = {};
#pragma unroll
        for (int d0 = 0; d0 < 4; ++d0) { p0 = __builtin_amdgcn_mfma_f32_32x32x16_bf16(kf[0][d0], qf[d0], p0, 0, 0, 0); p1 = __builtin_amdgcn_mfma_f32_32x32x16_bf16(kf[1][d0], qf[d0], p1, 0, 0, 0); }
#pragma unroll
        for (int i = 0; i < 8; ++i) *(LAS v4u*)(vlds + i * 1024 + lane * 16) = vv[i];
        const bool masked = (lim == 0x7fffffff) || (lim < kb + 64);
        const int ql = qpos < lim ? qpos : lim;
        const int klim = ql - kb - 4 * hi;
        if (masked) tile_math<true>(p0, p1, carry, klim, hi); else tile_math<false>(p0, p1, carry, klim, hi);
        v4u pa[4];
        pa[0] = (v4u){cvtpk(p0[0], p0[1]), cvtpk(p0[2], p0[3]), cvtpk(p0[4], p0[5]), cvtpk(p0[6], p0[7])};
        pa[1] = (v4u){cvtpk(p0[8], p0[9]), cvtpk(p0[10], p0[11]), cvtpk(p0[12], p0[13]), cvtpk(p0[14], p0[15])};
        pa[2] = (v4u){cvtpk(p1[0], p1[1]), cvtpk(p1[2], p1[3]), cvtpk(p1[4], p1[5]), cvtpk(p1[6], p1[7])};
        pa[3] = (v4u){cvtpk(p1[8], p1[9]), cvtpk(p1[10], p1[11]), cvtpk(p1[12], p1[13]), cvtpk(p1[14], p1[15])};
#pragma unroll
        for (int ks = 0; ks < 4; ++ks) {
            const s16x4 a0 = vtr(vrd + ks * 1024), a1 = vtr(vrd + ks * 1024 + 512), b0 = vtr(vrd + 4096 + ks * 1024), b1 = vtr(vrd + 4096 + ks * 1024 + 512);
            const bf16x8 v0 = (bf16x8){a0[0], a0[1], a0[2], a0[3], a1[0], a1[1], a1[2], a1[3]}, v1 = (bf16x8){b0[0], b0[1], b0[2], b0[3], b1[0], b1[1], b1[2], b1[3]};
            const bf16x8 pf = __builtin_bit_cast(bf16x8, pa[ks]);
            o0 = __builtin_amdgcn_mfma_f32_32x32x16_bf16(pf, v0, o0, 0, 0, 0);
            o1 = __builtin_amdgcn_mfma_f32_32x32x16_bf16(pf, v1, o1, 0, 0, 0);
        }
        if (kb == 0) break;
        if (__all(carry < THRESH_LOG2)) break;
        lim = kb; kb = kb >= 64 ? kb - 64 : 0;
    }
#pragma unroll
    for (int r = 0; r < 16; ++r) {
        const int q = q0 + (r & 3) + 8 * (r >> 2) + 4 * hi;
        const size_t off = (rowbase + q) * AW + h * HD + r32;
        const float g0 = __uint_as_float((unsigned)Gt[off] << 16), g1 = __uint_as_float((unsigned)Gt[off + 32] << 16);
        O[off] = (bf16)f2bf(o0[r] * g0); O[off + 32] = (bf16)f2bf(o1[r] * g1);
    }
}

__device__ __forceinline__ void attn_phase(Frame& F, const bf16* Q, const bf16* K, const bf16* V, const bf16* Gt, bf16* O) {
    LAS unsigned char* vlds = F.lds + RING_OFF + F.wave * 8192;
    const int gw = F.vcu * NWAVES + F.wave, NGW = F.G * NWAVES;
    constexpr int NQB = SEQ / 32, NU = BATCH * NH * NQB;
    for (int u = gw; u < NU; u += NGW) {
        const int bh = u / NQB, qblk = u % NQB;
        attn_unit(bh / NH, bh % NH, qblk, Q, K, V, Gt, O, vlds, F.lane);
    }
}
}

struct Args { Ptrs p; int never; int pad; };
__global__ void __launch_bounds__(NWAVES * 64, 2) yoco_fwd(Args args) {
    extern __shared__ __attribute__((aligned(16))) unsigned char lds[];
    Frame F;
    F.lds = (LAS unsigned char*)lds;
    F.tid = threadIdx.x; F.lane = F.tid & 63; F.wave = __builtin_amdgcn_readfirstlane(F.tid >> 6);
    F.G = gridDim.x; { const int bx = blockIdx.x; F.vcu = (F.G % 8 == 0) ? (bx % 8) * (F.G / 8) + bx / 8 : bx; }
    const Ptrs& A = args.p;
    unsigned char* ws = A.ws;
    gu32* ctl = (gu32*)(ws + WS_CTL);
    volatile LAS unsigned* MISC = (volatile LAS unsigned*)(F.lds + MISC_OFF);
    for (int u = F.tid; u < (LDS_BYTES - LDSCTL_OFF) / 4; u += NWAVES * 64) ((LAS unsigned*)(F.lds + LDSCTL_OFF))[u] = 0u;
    __syncthreads();
    if (args.never) cooperative_groups::this_grid().sync();
    XcdBarrier bar = xcd_barrier_post((unsigned*)(ctl + CW_BAR), MISC + 8);
#define GRID_BAR() xcd_barrier(bar)

    bf16* W1 = (bf16*)(ws + WS_W1); bf16* W2 = (bf16*)(ws + WS_W2); bf16* W3 = (bf16*)(ws + WS_W3); bf16* W4 = (bf16*)(ws + WS_W4);
    bf16* XB = (bf16*)(ws + WS_XB); bf16* PB = (bf16*)(ws + WS_P); bf16* BGB = (bf16*)(ws + WS_BG); bf16* YB = (bf16*)(ws + WS_Y);
    float* X1 = (float*)(ws + WS_X1); bf16* X1B = (bf16*)(ws + WS_X1B);
    float* rstd0 = (float*)(ws + WS_RSTD0); float* ssq1 = (float*)(ws + WS_SSQ1); float* ssq2 = (float*)(ws + WS_SSQ2);
    bf16* KB = (bf16*)(ws + WS_K); bf16* VB = (bf16*)(ws + WS_V); bf16* QB = (bf16*)(ws + WS_Q); bf16* GB = (bf16*)(ws + WS_G); bf16* OG = (bf16*)(ws + WS_OG);

    p0_prologue(F, A);
    GRID_BAR();
    { pg8::Gemm g{XB, W1, M, 4 * D, D}; pg8::StaticOrder S; S.init(M, 4 * D, F.G, (int)blockIdx.x);
      pg8::EpiMix1 E{rstd0, PB, BGB};
      pg8::gemm_phase<pg8::EpiMix1, pg8::StaticOrder, true, true>(F.lds + RING_OFF, g, S, E); }
    GRID_BAR();
    conv_pass(F, A);
    GRID_BAR();
    { pg8::Gemm g{YB, W2, M, D, D}; pg8::StaticOrder S; S.init(M, D, F.G, (int)blockIdx.x);
      pg8::EpiRes<true> E{A.x, X1, X1B, ssq1};
      pg8::gemm_phase<pg8::EpiRes<true>, pg8::StaticOrder, true, true>(F.lds + RING_OFF, g, S, E); }
    GRID_BAR();
    { pg8::Gemm g{X1B, W3, M, 2 * D, D}; pg8::StaticOrder S; S.init(M, 2 * D, F.G, (int)blockIdx.x);
      pg8::EpiKVQG E{ssq1, KB, (size_t)M * AW, RMS_EPS};
      pg8::gemm_phase<pg8::EpiKVQG, pg8::StaticOrder, true, true>(F.lds + RING_OFF, g, S, E); }
    GRID_BAR();
    sb::attn_phase(F, QB, KB, VB, GB, OG);
    GRID_BAR();
    { pg8::Gemm g{OG, W4, M, D, AW}; pg8::StaticOrder S; S.init(M, D, F.G, (int)blockIdx.x);
      pg8::EpiRes<false> E{X1, A.out, nullptr, ssq2};
      pg8::gemm_phase<pg8::EpiRes<false>, pg8::StaticOrder, true, true>(F.lds + RING_OFF, g, S, E); }
    GRID_BAR();
    final_norm(F, A);
#undef GRID_BAR
}

extern "C" void kernel_launch(void* const* d_in, const int* in_sizes, int n_in, void* d_out, int out_size, void* d_ws, size_t ws_size, hipStream_t stream) {
    static int grid = 0;
    if (grid == 0) {
        if (n_in != 11 || in_sizes[0] != M * D || out_size != M * D || ws_size < WS_END) { fprintf(stderr, "kernel_launch: unexpected shapes: n_in %d in0 %d out %d ws %zu (need %zu); nothing launched\n", n_in, n_in > 0 ? in_sizes[0] : -1, out_size, ws_size, (size_t)WS_END); grid = -1; return; }
        int dev = 0, cus = 0, per_cu = 0;
        if (hipGetDevice(&dev) != hipSuccess || hipDeviceGetAttribute(&cus, hipDeviceAttributeMultiprocessorCount, dev) != hipSuccess) { fprintf(stderr, "kernel_launch: device query failed\n"); grid = -1; return; }
        if (hipFuncSetAttribute((const void*)yoco_fwd, hipFuncAttributeMaxDynamicSharedMemorySize, LDS_BYTES) != hipSuccess) { fprintf(stderr, "kernel_launch: hipFuncSetAttribute failed\n"); grid = -1; return; }
        if (hipOccupancyMaxActiveBlocksPerMultiprocessor(&per_cu, (const void*)yoco_fwd, NWAVES * 64, LDS_BYTES) != hipSuccess || per_cu < 1) { fprintf(stderr, "kernel_launch: occupancy query says %d blocks per CU\n", per_cu); per_cu = 1; }
        (void)hipGetLastError();
        grid = cus;
    }
    if (grid < 0) return;
    if (hipMemsetAsync((char*)d_ws + WS_CTL, 0, CTL_ZERO_BYTES, stream) != hipSuccess) { fprintf(stderr, "kernel_launch: memset failed\n"); return; }
    Args a{};
    a.p.x = (const float*)d_in[0]; a.p.norm_a = (const float*)d_in[1]; a.p.w_in_a = (const float*)d_in[2]; a.p.conv_a = (const float*)d_in[3]; a.p.w_out_a = (const float*)d_in[4];
    a.p.norm_kv = (const float*)d_in[5]; a.p.w_kv = (const float*)d_in[6]; a.p.norm_b = (const float*)d_in[7]; a.p.w_in_b = (const float*)d_in[8]; a.p.w_out_b = (const float*)d_in[9]; a.p.norm_f = (const float*)d_in[10];
    a.p.out = (float*)d_out; a.p.ws = (unsigned char*)d_ws; a.never = 0; a.pad = 0;
    void* kargs[] = {&a};
    const hipError_t le = hipLaunchCooperativeKernel((const void*)yoco_fwd, dim3(grid), dim3(NWAVES * 64), kargs, LDS_BYTES, stream);
    if (le != hipSuccess) fprintf(stderr, "kernel_launch: cooperative launch failed: %s (grid %d)\n", hipGetErrorName(le), grid);
}
```
